# Optimizing an MI355X kernel written in HIP

```python
import jax, jax.numpy as jnp
from jax import lax
import numpy as np

D_MODEL = 1024
BATCH = 8
SEQ = 4096
DEPTH = 1

CHUNK = 64
Q_BLOCK = 128
HEAD_DIM = 64
FOX_HEADS = D_MODEL // 2 // HEAD_DIM
RWKV_HEADS = D_MODEL // 2 // HEAD_DIM
FOX_WIDTH = FOX_HEADS * HEAD_DIM
RWKV_WIDTH = RWKV_HEADS * HEAD_DIM
MIX_WIDTH = FOX_WIDTH + RWKV_WIDTH
DECAY_LORA = 64
AAA_LORA = 64
GATE_LORA = 160
D_FF = ((8 * D_MODEL // 3 + 255) // 256) * 256
NORM_EPS = 1e-6
LNX_EPS = 64e-5

FOX_COLS = 3 * FOX_WIDTH + FOX_HEADS
RWKV_COLS = 3 * RWKV_WIDTH + DECAY_LORA + AAA_LORA + GATE_LORA
W_IN_COLS = FOX_COLS + RWKV_COLS

kernel_name = "fox_rwkv7_hybrid_block"


def rmsnorm(x, g):
    x32 = x.astype(jnp.float32)
    y = x32 * lax.rsqrt(jnp.mean(x32 * x32, axis=-1, keepdims=True) + NORM_EPS)
    return y.astype(x.dtype) * g


def forgetting_attention(q, k, v, f_logit, f_bias):
    B, T, H, D = q.shape
    q = jnp.transpose(q, (0, 2, 1, 3))
    k = jnp.transpose(k, (0, 2, 1, 3))
    v = jnp.transpose(v, (0, 2, 1, 3))
    log_f = jax.nn.log_sigmoid(f_logit.astype(jnp.float32) + f_bias.astype(jnp.float32))
    c = jnp.cumsum(jnp.transpose(log_f, (0, 2, 1)), axis=-1)
    scale = D ** -0.5
    outs = []
    for i in range(T // Q_BLOCK):
        q0, q1 = i * Q_BLOCK, (i + 1) * Q_BLOCK
        s = jnp.einsum('bhqd,bhkd->bhqk', q[:, :, q0:q1], k[:, :, :q1]).astype(jnp.float32) * scale
        s = s + c[:, :, q0:q1, None] - c[:, :, None, :q1]
        mask = jnp.arange(q1)[None, :] <= (q0 + jnp.arange(Q_BLOCK))[:, None]
        s = jnp.where(mask, s, -jnp.inf)
        p = jax.nn.softmax(s, axis=-1).astype(v.dtype)
        outs.append(jnp.einsum('bhqk,bhkd->bhqd', p, v[:, :, :q1]))
    o = jnp.concatenate(outs, axis=2)
    return jnp.transpose(o, (0, 2, 1, 3)).reshape(B, T, H * D)


def rwkv7_scan(r, w, k, v, a, b):
    B, T, H, D = r.shape
    tm = lambda z: jnp.moveaxis(z.astype(jnp.float32), 1, 0)

    def step(S, inp):
        r_t, w_t, k_t, v_t, a_t, b_t = inp
        Sa = jnp.einsum('bhij,bhj->bhi', S, a_t)
        S = S * w_t[:, :, None, :] + Sa[..., None] * b_t[:, :, None, :] + v_t[..., None] * k_t[:, :, None, :]
        return S, jnp.einsum('bhij,bhj->bhi', S, r_t)

    S0 = jnp.zeros((B, H, D, D), jnp.float32)
    _, y = lax.scan(step, S0, (tm(r), tm(w), tm(k), tm(v), tm(a), tm(b)))
    return jnp.moveaxis(y, 0, 1).astype(r.dtype)


def rwkv7_time_mix(p, shift_mu, w0, w_up, a0, a_up, g_up, k_k, k_a, r_k, ln_w, ln_b):
    B, T, _ = p.shape
    H, D = RWKV_HEADS, HEAD_DIM
    p_prev = jnp.concatenate([jnp.zeros_like(p[:, :1]), p[:, :-1]], axis=1)
    p = p + shift_mu * (p_prev - p)
    r, k, v, w_lat, a_lat, g_lat = jnp.split(
        p, np.cumsum([RWKV_WIDTH, RWKV_WIDTH, RWKV_WIDTH, DECAY_LORA, AAA_LORA]).tolist(), axis=-1)
    w = -jax.nn.softplus(-(w0 + jnp.tanh(w_lat) @ w_up)) - 0.5
    decay = jnp.exp(-jnp.exp(w.astype(jnp.float32)))
    a = jax.nn.sigmoid(a0 + a_lat @ a_up)
    g = jax.nn.sigmoid(g_lat) @ g_up
    heads = lambda z: z.reshape(B, T, H, D)
    kk = heads(k * k_k).astype(jnp.float32)
    kk = kk / jnp.maximum(jnp.linalg.norm(kk, axis=-1, keepdims=True), 1e-12)
    k = k * (1.0 + (a - 1.0) * k_a)
    rh, kh, vh, ah = heads(r), heads(k), heads(v), heads(a)
    y = rwkv7_scan(rh, heads(decay), kh, vh, -kk, kk * ah.astype(jnp.float32))
    y32 = y.astype(jnp.float32)
    mu = jnp.mean(y32, axis=-1, keepdims=True)
    var = jnp.mean(jnp.square(y32 - mu), axis=-1, keepdims=True)
    y = ((y32 - mu) * lax.rsqrt(var + LNX_EPS)).astype(r.dtype).reshape(B, T, H * D) * ln_w + ln_b
    bonus = jnp.sum(rh * kh * r_k, axis=-1, keepdims=True) * vh
    return (y + bonus.reshape(B, T, H * D)) * g


def setup_inputs(seed: int = 0) -> dict:
    key = jax.random.key(seed)
    ks = jax.random.split(key, 24)
    L = DEPTH
    nrm = lambda k, shape, s: jax.random.normal(k, shape, jnp.float32) * s
    gain = lambda k, n: 1.0 + nrm(k, (L, n), 0.02)
    return {
        "x": jax.random.normal(ks[0], (BATCH, SEQ, D_MODEL), jnp.float32),
        "attn_norm_pre": gain(ks[1], D_MODEL),
        "attn_norm_post": gain(ks[2], D_MODEL),
        "w_in": nrm(ks[3], (L, D_MODEL, W_IN_COLS), D_MODEL ** -0.5),
        "fox_forget_bias": 2.0 + nrm(ks[4], (L, FOX_HEADS), 0.5),
        "shift_mu": jax.random.uniform(ks[5], (L, RWKV_COLS), jnp.float32),
        "rwkv_w0": -6.5 + 5.0 * jax.random.uniform(ks[6], (L, RWKV_WIDTH), jnp.float32),
        "rwkv_w_up": nrm(ks[7], (L, DECAY_LORA, RWKV_WIDTH), 0.1 * DECAY_LORA ** -0.5),
        "rwkv_a0": nrm(ks[8], (L, RWKV_WIDTH), 0.1),
        "rwkv_a_up": nrm(ks[9], (L, AAA_LORA, RWKV_WIDTH), AAA_LORA ** -0.5),
        "rwkv_g_up": nrm(ks[10], (L, GATE_LORA, RWKV_WIDTH), GATE_LORA ** -0.5),
        "rwkv_k_k": 0.85 + nrm(ks[11], (L, RWKV_WIDTH), 0.05),
        "rwkv_k_a": 1.0 + nrm(ks[12], (L, RWKV_WIDTH), 0.05),
        "rwkv_r_k": nrm(ks[13], (L, RWKV_HEADS, HEAD_DIM), 0.1),
        "rwkv_ln_w": 1.0 + nrm(ks[14], (L, RWKV_WIDTH), 0.02),
        "rwkv_ln_b": nrm(ks[15], (L, RWKV_WIDTH), 0.02),
        "w_out": nrm(ks[16], (L, MIX_WIDTH, D_MODEL), MIX_WIDTH ** -0.5),
        "ffn_norm_pre": gain(ks[17], D_MODEL),
        "ffn_norm_post": gain(ks[18], D_MODEL),
        "ffn_w_gate": nrm(ks[19], (L, D_MODEL, D_FF), D_MODEL ** -0.5),
        "ffn_w_up": nrm(ks[20], (L, D_MODEL, D_FF), D_MODEL ** -0.5),
        "ffn_w_down": nrm(ks[21], (L, D_FF, D_MODEL), D_FF ** -0.5),
    }


def reference(x, attn_norm_pre, attn_norm_post, w_in, fox_forget_bias, shift_mu,
              rwkv_w0, rwkv_w_up, rwkv_a0, rwkv_a_up, rwkv_g_up, rwkv_k_k, rwkv_k_a,
              rwkv_r_k, rwkv_ln_w, rwkv_ln_b, w_out, ffn_norm_pre, ffn_norm_post,
              ffn_w_gate, ffn_w_up, ffn_w_down):
    B, T, _ = x.shape
    h = x
    for l in range(DEPTH):
        u = rmsnorm(h, attn_norm_pre[l])
        proj = u @ w_in[l]
        p_fox, p_rwkv = proj[..., :FOX_COLS], proj[..., FOX_COLS:]
        fq, fk, fv, ff = jnp.split(p_fox, [FOX_WIDTH, 2 * FOX_WIDTH, 3 * FOX_WIDTH], axis=-1)
        fh = lambda z: z.reshape(B, T, FOX_HEADS, HEAD_DIM)
        o_fox = forgetting_attention(fh(fq), fh(fk), fh(fv), ff, fox_forget_bias[l])
        o_rwkv = rwkv7_time_mix(p_rwkv, shift_mu[l], rwkv_w0[l], rwkv_w_up[l], rwkv_a0[l],
                                rwkv_a_up[l], rwkv_g_up[l], rwkv_k_k[l], rwkv_k_a[l],
                                rwkv_r_k[l], rwkv_ln_w[l], rwkv_ln_b[l])
        mix = jnp.concatenate([o_fox, o_rwkv], axis=-1) @ w_out[l]
        h = h + rmsnorm(mix, attn_norm_post[l])
        z = rmsnorm(h, ffn_norm_pre[l])
        f = (jax.nn.silu(z @ ffn_w_gate[l]) * (z @ ffn_w_up[l])) @ ffn_w_down[l]
        h = h + rmsnorm(f, ffn_norm_post[l])
    return h
```

```cpp
#include <hip/hip_runtime.h>
#include <cstdio>
#include <cstdint>

namespace {
constexpr int DM = 1024, NB = 8, T = 4096, HD = 64, NH = 8;
constexpr int WIN = 3368, FOXC = 1544, DFF = 2816;
constexpr int C_FQ = 0, C_FK = 512, C_FV = 1024, C_FF = 1536;
constexpr int C_R = 1544;
constexpr float NORM_EPS = 1e-6f, LNX_EPS = 64e-5f;

__device__ __forceinline__ float wave_sum(float v) {
#pragma unroll
    for (int o = 1; o < 64; o <<= 1) v += __shfl_xor(v, o);
    return v;
}

__global__ void __launch_bounds__(256) k_rmsnorm(const float* __restrict__ in, const float* __restrict__ g, const float* res, float* out, int rows) {
    const int row = blockIdx.x * 4 + (threadIdx.x >> 6), lane = threadIdx.x & 63;
    if (row >= rows) return;
    const float4* p = (const float4*)(in + (size_t)row * DM);
    float4 v[4]; float s = 0.f;
#pragma unroll
    for (int j = 0; j < 4; ++j) { v[j] = p[lane + 64 * j]; s += v[j].x * v[j].x + v[j].y * v[j].y + v[j].z * v[j].z + v[j].w * v[j].w; }
    s = wave_sum(s);
    const float rs = rsqrtf(s * (1.f / DM) + NORM_EPS);
    const float4* gp = (const float4*)g;
    float4* o = (float4*)(out + (size_t)row * DM);
#pragma unroll
    for (int j = 0; j < 4; ++j) {
        const float4 gg = gp[lane + 64 * j];
        float4 r = {v[j].x * rs * gg.x, v[j].y * rs * gg.y, v[j].z * rs * gg.z, v[j].w * rs * gg.w};
        if (res) { const float4 b = ((const float4*)(res + (size_t)row * DM))[lane + 64 * j]; r.x += b.x; r.y += b.y; r.z += b.z; r.w += b.w; }
        o[lane + 64 * j] = r;
    }
}

__global__ void __launch_bounds__(256) k_sgemm(const float* __restrict__ A, int lda, const float* __restrict__ B, int ldb, float* __restrict__ C, int ldc, int N, int K) {
    __shared__ float As[16][132];
    __shared__ float Bs[16][132];
    const int tid = threadIdx.x, tx = tid & 15, ty = tid >> 4;
    const int m0 = blockIdx.y * 128, n0 = blockIdx.x * 128;
    float acc[8][8];
#pragma unroll
    for (int i = 0; i < 8; ++i)
#pragma unroll
        for (int j = 0; j < 8; ++j) acc[i][j] = 0.f;
    const int ar = tid >> 1, ac = (tid & 1) * 8;
    const int bk = tid >> 4, bc = (tid & 15) * 8;
    for (int k0 = 0; k0 < K; k0 += 16) {
        const float4 a0 = *(const float4*)(A + (size_t)(m0 + ar) * lda + k0 + ac);
        const float4 a1 = *(const float4*)(A + (size_t)(m0 + ar) * lda + k0 + ac + 4);
        float4 b0 = {0.f, 0.f, 0.f, 0.f}, b1 = {0.f, 0.f, 0.f, 0.f};
        if (n0 + bc < N) b0 = *(const float4*)(B + (size_t)(k0 + bk) * ldb + n0 + bc);
        if (n0 + bc + 4 < N) b1 = *(const float4*)(B + (size_t)(k0 + bk) * ldb + n0 + bc + 4);
        __syncthreads();
        As[ac + 0][ar] = a0.x; As[ac + 1][ar] = a0.y; As[ac + 2][ar] = a0.z; As[ac + 3][ar] = a0.w;
        As[ac + 4][ar] = a1.x; As[ac + 5][ar] = a1.y; As[ac + 6][ar] = a1.z; As[ac + 7][ar] = a1.w;
        *(float4*)&Bs[bk][bc] = b0; *(float4*)&Bs[bk][bc + 4] = b1;
        __syncthreads();
#pragma unroll
        for (int k = 0; k < 16; ++k) {
            const float4 x0 = *(const float4*)&As[k][ty * 8], x1 = *(const float4*)&As[k][ty * 8 + 4];
            const float4 y0 = *(const float4*)&Bs[k][tx * 8], y1 = *(const float4*)&Bs[k][tx * 8 + 4];
            const float a[8] = {x0.x, x0.y, x0.z, x0.w, x1.x, x1.y, x1.z, x1.w};
            const float b[8] = {y0.x, y0.y, y0.z, y0.w, y1.x, y1.y, y1.z, y1.w};
#pragma unroll
            for (int i = 0; i < 8; ++i)
#pragma unroll
                for (int j = 0; j < 8; ++j) acc[i][j] = fmaf(a[i], b[j], acc[i][j]);
        }
    }
#pragma unroll
    for (int i = 0; i < 8; ++i) {
        float* crow = C + (size_t)(m0 + ty * 8 + i) * ldc + n0 + tx * 8;
        if (n0 + tx * 8 < N) *(float4*)crow = float4{acc[i][0], acc[i][1], acc[i][2], acc[i][3]};
        if (n0 + tx * 8 + 4 < N) *(float4*)(crow + 4) = float4{acc[i][4], acc[i][5], acc[i][6], acc[i][7]};
    }
}

__device__ __forceinline__ float log_sigmoid(float x) { return fminf(x, 0.f) - log1pf(expf(-fabsf(x))); }
__device__ __forceinline__ float sigmoidf(float x) { return 1.f / (1.f + expf(-x)); }

__global__ void __launch_bounds__(256) k_fox_cumsum(const float* __restrict__ proj, const float* __restrict__ fbias, float* __restrict__ c) {
    __shared__ float part[256];
    const int h = blockIdx.x, tid = threadIdx.x;
    const float b = fbias[h];
    float loc[16]; float s = 0.f;
#pragma unroll
    for (int i = 0; i < 16; ++i) { s += log_sigmoid(proj[(size_t)(tid * 16 + i) * WIN + C_FF + h] + b); loc[i] = s; }
    part[tid] = s; __syncthreads();
    if (tid == 0) { float run = 0.f; for (int i = 0; i < 256; ++i) { const float v = part[i]; part[i] = run; run += v; } }
    __syncthreads();
    const float off = part[tid];
#pragma unroll
    for (int i = 0; i < 16; ++i) c[(size_t)h * T + tid * 16 + i] = loc[i] + off;
}

__global__ void __launch_bounds__(64) k_fox_attn(const float* __restrict__ proj, const float* __restrict__ c, float* __restrict__ ox) {
    __shared__ float Ks[64 * 64];
    __shared__ float Vs[64 * 64];
    __shared__ float Cs[64];
    const int qb = blockIdx.x, h = blockIdx.y, lane = threadIdx.x;
    const int t = qb * 64 + lane;
    float q[64], o[64];
#pragma unroll
    for (int d = 0; d < 64; d += 4) { const float4 v = *(const float4*)(proj + (size_t)t * WIN + C_FQ + h * 64 + d); q[d] = v.x * 0.125f; q[d + 1] = v.y * 0.125f; q[d + 2] = v.z * 0.125f; q[d + 3] = v.w * 0.125f; }
#pragma unroll
    for (int d = 0; d < 64; ++d) o[d] = 0.f;
    const float ct = c[(size_t)h * T + t];
    float m = -INFINITY, l = 0.f;
    for (int kt = 0; kt <= qb; ++kt) {
        __syncthreads();
#pragma unroll
        for (int i = 0; i < 16; ++i) { const int idx = i * 64 + lane, r = idx >> 4, c4 = (idx & 15) * 4;
            *(float4*)&Ks[r * 64 + c4] = *(const float4*)(proj + (size_t)(kt * 64 + r) * WIN + C_FK + h * 64 + c4);
            *(float4*)&Vs[r * 64 + c4] = *(const float4*)(proj + (size_t)(kt * 64 + r) * WIN + C_FV + h * 64 + c4); }
        Cs[lane] = c[(size_t)h * T + kt * 64 + lane];
        __syncthreads();
        for (int s = 0; s < 64; ++s) {
            float x = 0.f;
#pragma unroll
            for (int d = 0; d < 64; ++d) x = fmaf(q[d], Ks[s * 64 + d], x);
            x += ct - Cs[s];
            const bool ok = (kt * 64 + s) <= t;
            if (ok && x > m) { const float sc = expf(m - x); l *= sc;
#pragma unroll
                for (int d = 0; d < 64; ++d) o[d] *= sc;
                m = x; }
            const float p = ok ? expf(x - m) : 0.f;
            l += p;
#pragma unroll
            for (int d = 0; d < 64; ++d) o[d] = fmaf(p, Vs[s * 64 + d], o[d]);
        }
    }
    const float il = 1.f / l;
#pragma unroll
    for (int d = 0; d < 64; d += 4) *(float4*)(ox + (size_t)t * DM + h * 64 + d) = float4{o[d] * il, o[d + 1] * il, o[d + 2] * il, o[d + 3] * il};
}

struct RwkvParams { const float *mu, *w0, *w_up, *a0, *a_up, *g_up, *k_k, *k_a, *r_k, *ln_w, *ln_b; };
__global__ void __launch_bounds__(512) k_rwkv_prep(const float* __restrict__ proj, RwkvParams P, float* __restrict__ R, float* __restrict__ Kp, float* __restrict__ V,
                                                   float* __restrict__ DEC, float* __restrict__ AP, float* __restrict__ BP, float* __restrict__ G) {
    __shared__ float ps[1824];
    __shared__ float tw[64], sg[160];
    const int t = blockIdx.x, n = threadIdx.x;
    const float* p = proj + (size_t)t * WIN + C_R;
    for (int cidx = n; cidx < 1824; cidx += 512) { const float cur = p[cidx], prev = (t > 0) ? p[cidx - WIN] : 0.f; ps[cidx] = cur + P.mu[cidx] * (prev - cur); }
    __syncthreads();
    if (n < 64) tw[n] = tanhf(ps[1536 + n]);
    if (n >= 64 && n < 224) sg[n - 64] = sigmoidf(ps[1664 + n - 64]);
    __syncthreads();
    float wr = P.w0[n], ar = P.a0[n], g = 0.f;
#pragma unroll 4
    for (int l = 0; l < 64; ++l) { wr = fmaf(tw[l], P.w_up[l * 512 + n], wr); ar = fmaf(ps[1600 + l], P.a_up[l * 512 + n], ar); }
#pragma unroll 4
    for (int l = 0; l < 160; ++l) g = fmaf(sg[l], P.g_up[l * 512 + n], g);
    const float w = log_sigmoid(wr) - 0.5f;
    const float dec = expf(-expf(w));
    const float a = sigmoidf(ar);
    const float k = ps[512 + n];
    float kk = k * P.k_k[n];
    const float nrm = fmaxf(sqrtf(wave_sum(kk * kk)), 1e-12f);
    kk = kk / nrm;
    const size_t o = (size_t)t * 512 + n;
    R[o] = ps[n]; Kp[o] = k * (1.f + (a - 1.f) * P.k_a[n]); V[o] = ps[1024 + n];
    DEC[o] = dec; AP[o] = -kk; BP[o] = kk * a; G[o] = g;
}

__global__ void __launch_bounds__(256) k_rwkv_scan(const float* __restrict__ R, const float* __restrict__ Kp, const float* __restrict__ V, const float* __restrict__ DEC,
                                                   const float* __restrict__ AP, const float* __restrict__ BP, float* __restrict__ Y) {
    __shared__ float sh[6][16][64];
    const int h = blockIdx.x, tid = threadIdx.x, i = tid >> 2, jq = tid & 3;
    float S[16];
#pragma unroll
    for (int j = 0; j < 16; ++j) S[j] = 0.f;
    for (int t0 = 0; t0 < T; t0 += 16) {
        __syncthreads();
        for (int e = tid; e < 16 * 64; e += 256) { const int st = e >> 6, cc = e & 63; const size_t o = (size_t)(t0 + st) * 512 + h * 64 + cc;
            sh[0][st][cc] = DEC[o]; sh[1][st][cc] = AP[o]; sh[2][st][cc] = BP[o]; sh[3][st][cc] = Kp[o]; sh[4][st][cc] = R[o]; sh[5][st][cc] = V[o]; }
        __syncthreads();
        for (int st = 0; st < 16; ++st) {
            float sa = 0.f;
#pragma unroll
            for (int j = 0; j < 16; ++j) sa = fmaf(S[j], sh[1][st][16 * jq + j], sa);
            sa += __shfl_xor(sa, 1); sa += __shfl_xor(sa, 2);
            const float v = sh[5][st][i];
            float y = 0.f;
#pragma unroll
            for (int j = 0; j < 16; ++j) { const int jj = 16 * jq + j; S[j] = S[j] * sh[0][st][jj] + sa * sh[2][st][jj] + v * sh[3][st][jj]; y = fmaf(S[j], sh[4][st][jj], y); }
            y += __shfl_xor(y, 1); y += __shfl_xor(y, 2);
            if (jq == 0) Y[(size_t)(t0 + st) * 512 + h * 64 + i] = y;
        }
    }
}

__global__ void __launch_bounds__(256) k_rwkv_post(const float* __restrict__ Y, const float* __restrict__ R, const float* __restrict__ Kp, const float* __restrict__ V, const float* __restrict__ G,
                                                   RwkvParams P, float* __restrict__ ox) {
    const int w = blockIdx.x * 4 + (threadIdx.x >> 6), lane = threadIdx.x & 63;
    const int t = w >> 3, h = w & 7, n = h * 64 + lane;
    const size_t o = (size_t)t * 512 + n;
    const float y = Y[o];
    const float mu = wave_sum(y) * (1.f / 64.f);
    const float d = y - mu;
    const float var = wave_sum(d * d) * (1.f / 64.f);
    const float yn = d * rsqrtf(var + LNX_EPS) * P.ln_w[n] + P.ln_b[n];
    const float s = wave_sum(R[o] * Kp[o] * P.r_k[n]);
    ox[(size_t)t * DM + 512 + n] = (yn + s * V[o]) * G[o];
}

__global__ void __launch_bounds__(256) k_silu_mul(float* __restrict__ g, const float* __restrict__ u, size_t n4) {
    const size_t i = (size_t)blockIdx.x * 256 + threadIdx.x;
    if (i >= n4) return;
    float4 a = ((float4*)g)[i]; const float4 b = ((const float4*)u)[i];
    a.x = a.x * sigmoidf(a.x) * b.x; a.y = a.y * sigmoidf(a.y) * b.y; a.z = a.z * sigmoidf(a.z) * b.z; a.w = a.w * sigmoidf(a.w) * b.w;
    ((float4*)g)[i] = a;
}
}

extern "C" void kernel_launch(void* const* d_in, const int* in_sizes, int n_in, void* d_out, int out_size, void* d_ws, size_t ws_size, hipStream_t stream) {
    if (n_in != 22 || out_size != NB * T * DM) { fprintf(stderr, "kernel_launch: unexpected shapes\n"); return; }
    const float* x = (const float*)d_in[0];
    const float *g_pre = (const float*)d_in[1], *g_post = (const float*)d_in[2], *w_in = (const float*)d_in[3], *fbias = (const float*)d_in[4];
    RwkvParams P{(const float*)d_in[5], (const float*)d_in[6], (const float*)d_in[7], (const float*)d_in[8], (const float*)d_in[9], (const float*)d_in[10],
                 (const float*)d_in[11], (const float*)d_in[12], (const float*)d_in[13], (const float*)d_in[14], (const float*)d_in[15]};
    const float *w_out = (const float*)d_in[16], *g_pre2 = (const float*)d_in[17], *g_post2 = (const float*)d_in[18];
    const float *w_gate = (const float*)d_in[19], *w_up = (const float*)d_in[20], *w_down = (const float*)d_in[21];
    float* out = (float*)d_out;
    float* ws = (float*)d_ws; size_t off = 0;
    auto take = [&](size_t n) { float* p = ws + off; off += (n + 63) & ~(size_t)63; return p; };
    float* u = take((size_t)T * DM); float* proj = take((size_t)T * WIN); float* cc = take((size_t)NH * T);
    float* R = take((size_t)T * 512); float* Kp = take((size_t)T * 512); float* V = take((size_t)T * 512); float* DEC = take((size_t)T * 512);
    float* AP = take((size_t)T * 512); float* BP = take((size_t)T * 512); float* G = take((size_t)T * 512); float* Y = take((size_t)T * 512);
    float* ox = take((size_t)T * DM); float* mix = take((size_t)T * DM); float* z = take((size_t)T * DM);
    float* gg = take((size_t)T * DFF); float* uu = take((size_t)T * DFF); float* f = take((size_t)T * DM);
    if (off * 4 > ws_size) { fprintf(stderr, "kernel_launch: workspace too small\n"); return; }
    for (int b = 0; b < NB; ++b) {
        const float* xb = x + (size_t)b * T * DM; float* hb = out + (size_t)b * T * DM;
        k_rmsnorm<<<T / 4, 256, 0, stream>>>(xb, g_pre, nullptr, u, T);
        k_sgemm<<<dim3((WIN + 127) / 128, T / 128), 256, 0, stream>>>(u, DM, w_in, WIN, proj, WIN, WIN, DM);
        k_fox_cumsum<<<NH, 256, 0, stream>>>(proj, fbias, cc);
        k_fox_attn<<<dim3(T / 64, NH), 64, 0, stream>>>(proj, cc, ox);
        k_rwkv_prep<<<T, 512, 0, stream>>>(proj, P, R, Kp, V, DEC, AP, BP, G);
        k_rwkv_scan<<<NH, 256, 0, stream>>>(R, Kp, V, DEC, AP, BP, Y);
        k_rwkv_post<<<T * NH / 4, 256, 0, stream>>>(Y, R, Kp, V, G, P, ox);
        k_sgemm<<<dim3(DM / 128, T / 128), 256, 0, stream>>>(ox, DM, w_out, DM, mix, DM, DM, DM);
        k_rmsnorm<<<T / 4, 256, 0, stream>>>(mix, g_post, xb, hb, T);
        k_rmsnorm<<<T / 4, 256, 0, stream>>>(hb, g_pre2, nullptr, z, T);
        k_sgemm<<<dim3(DFF / 128, T / 128), 256, 0, stream>>>(z, DM, w_gate, DFF, gg, DFF, DFF, DM);
        k_sgemm<<<dim3(DFF / 128, T / 128), 256, 0, stream>>>(z, DM, w_up, DFF, uu, DFF, DFF, DM);
        k_silu_mul<<<(unsigned)(((size_t)T * DFF / 4 + 255) / 256), 256, 0, stream>>>(gg, uu, (size_t)T * DFF / 4);
        k_sgemm<<<dim3(DM / 128, T / 128), 256, 0, stream>>>(gg, DFF, w_down, DM, f, DM, DM, DFF);
        k_rmsnorm<<<T / 4, 256, 0, stream>>>(f, g_post2, hb, hb, T);
    }
}
```
